# Optimizing an MI355X kernel written in HIP

```python
import jax, jax.numpy as jnp
from jax import lax
import numpy as np

D_MODEL = 1024
BATCH = 8
SEQ = 2048
DEPTH = 2
DEC_BATCH = 128
DEC_SEQ = 8
PAST_LEN = 16384
PAGE_SIZE = 128

N_EVEN = (DEPTH + 1) // 2
N_ODD = DEPTH // 2
D_POOL = D_MODEL // 2
POOL_WINDOWS = (2, 4, 8, 16)
N_POOL_GROUPS = len(POOL_WINDOWS)
POOL_GROUP = D_POOL // N_POOL_GROUPS
POOL_BUF = max(POOL_WINDOWS) - 1
D_SCONV = D_MODEL // 2
CONV_W = 3
CONV_BUF = CONV_W - 1
D_PROJ0 = D_POOL + 3 * D_SCONV
D_MIX0 = D_POOL + D_SCONV
D_GATE = D_MODEL
CHUNK = 128
N_SG_HEADS = 8
SG_HEAD = D_GATE // N_SG_HEADS
D_FF = 2816
N_MOD = 6
EPS = 1e-6

kernel_name = "hybrid_pool_sconv_sgmlp_convffn_step"


def rmsnorm(x, g):
    xf = x.astype(jnp.float32)
    y = xf * lax.rsqrt(jnp.mean(xf * xf, axis=-1, keepdims=True) + EPS)
    return (y * g.astype(jnp.float32)).astype(x.dtype)


def causal_dwconv(x, prev, w, b):
    L = x.shape[1]
    ext = jnp.concatenate([prev.astype(x.dtype), x], axis=1)
    y = b
    for k in range(CONV_W):
        y = y + w[k] * ext[:, k:k + L]
    return y, ext[:, -CONV_BUF:]


def pool_mixer(a, prev, start_pos, w_pool, s_pool):
    B, L, _ = a.shape
    ext = jnp.concatenate([prev.astype(a.dtype), a], axis=1)
    cs = jnp.cumsum(ext.astype(jnp.float32), axis=1)
    cs = jnp.concatenate([jnp.zeros((B, 1, D_POOL), jnp.float32), cs], axis=1)
    end = cs[:, POOL_BUF + 1:]
    pos = jnp.arange(L, dtype=jnp.int32) + start_pos
    means = []
    for g, w in enumerate(POOL_WINDOWS):
        sl = slice(g * POOL_GROUP, (g + 1) * POOL_GROUP)
        s = end[..., sl] - cs[:, POOL_BUF + 1 - w:POOL_BUF + 1 - w + L, sl]
        cnt = jnp.minimum(w, pos + 1).astype(jnp.float32)[None, :, None]
        means.append(s / cnt)
    d = (jnp.concatenate(means, axis=-1) - a.astype(jnp.float32)).astype(a.dtype)
    d = d.reshape(B, L, N_POOL_GROUPS, POOL_GROUP)
    y = jnp.einsum('blgc,gcd->blgd', d, w_pool).reshape(B, L, D_POOL) * s_pool
    return y, ext[:, -POOL_BUF:]


def spatial_gating(v, w_s, b_s):
    B, L, _ = v.shape
    n_chunks = -(-L // CHUNK)
    pad = n_chunks * CHUNK - L
    vp = jnp.pad(v, ((0, 0), (0, pad), (0, 0))).reshape(B, n_chunks, CHUNK, N_SG_HEADS, SG_HEAD)
    mask = jnp.tril(jnp.ones((CHUNK, CHUNK), dtype=bool))
    wm = jnp.where(mask[None], w_s, jnp.zeros((), w_s.dtype))
    z = jnp.einsum('hts,bnshd->bnthd', wm, vp) + b_s.T[None, None, :, :, None]
    return z.reshape(B, n_chunks * CHUNK, D_GATE)[:, :L]


def trunk(x, c, start_pos, pool_prev, sconv_prev, ffn_prev,
          norm_mix, norm_ffn, w_ada, b_ada, w_in0, w_pool, s_pool, sconv_w, sconv_b,
          w_out0, w_uv1, g_v1, w_s1, b_s1, w_out1, ffn_up, ffn_conv_w, ffn_conv_b,
          ffn_down, norm_final):
    new_pool, new_sconv, new_ffn, new_v = [], [], [], []
    for l in range(DEPTH):
        mod = jax.nn.silu(c) @ w_ada[l] + b_ada[l]
        sh1, sc1, g1, sh2, sc2, g2 = [m[:, None, :] for m in jnp.split(mod, N_MOD, axis=-1)]
        h = rmsnorm(x, norm_mix[l]) * (1 + sc1) + sh1
        if l % 2 == 0:
            e = l // 2
            proj = h @ w_in0[e]
            a, xin, bg, cg = jnp.split(proj, [D_POOL, D_POOL + D_SCONV, D_POOL + 2 * D_SCONV], axis=-1)
            ya, npool = pool_mixer(a, pool_prev[e], start_pos, w_pool[e], s_pool[e])
            yc, nconv = causal_dwconv(cg * xin, sconv_prev[e], sconv_w[e], sconv_b[e])
            yb = bg * yc
            mix = jnp.concatenate([ya, yb], axis=-1) @ w_out0[e]
            new_pool.append(npool)
            new_sconv.append(nconv)
        else:
            o = l // 2
            uv = jax.nn.gelu(h @ w_uv1[o])
            u, v = jnp.split(uv, 2, axis=-1)
            v = rmsnorm(v, g_v1[o])
            mix = (u * spatial_gating(v, w_s1[o], b_s1[o])) @ w_out1[o]
            new_v.append(v)
        x = x + g1 * mix
        h = rmsnorm(x, norm_ffn[l]) * (1 + sc2) + sh2
        up, nffn = causal_dwconv(h @ ffn_up[l], ffn_prev[l], ffn_conv_w[l], ffn_conv_b[l])
        ga, va = jnp.split(up, 2, axis=-1)
        x = x + g2 * ((jax.nn.gelu(ga) * va) @ ffn_down[l])
        new_ffn.append(nffn)
    y = rmsnorm(x, norm_final)
    return y, jnp.stack(new_pool), jnp.stack(new_sconv), jnp.stack(new_ffn), jnp.stack(new_v)


def setup_inputs(seed: int = 0) -> dict:
    key = jax.random.key(seed)
    ks = jax.random.split(key, 32)
    n = lambda k, s, sc=1.0: jax.random.normal(k, s, jnp.float32) * sc
    return {
        "x_prompt": n(ks[0], (BATCH, SEQ, D_MODEL)),
        "x_sample": n(ks[1], (DEC_BATCH, DEC_SEQ, D_MODEL)),
        "state_pool": n(ks[2], (N_EVEN, DEC_BATCH, POOL_BUF, D_POOL)),
        "state_sconv": n(ks[3], (N_EVEN, DEC_BATCH, CONV_BUF, D_SCONV)),
        "state_ffn": n(ks[4], (DEPTH, DEC_BATCH, CONV_BUF, 2 * D_FF)),
        "c_prompt": n(ks[5], (BATCH, D_MODEL)),
        "c_sample": n(ks[6], (DEC_BATCH, D_MODEL)),
        "norm_mix": 1.0 + n(ks[7], (DEPTH, D_MODEL), 0.02),
        "norm_ffn": 1.0 + n(ks[8], (DEPTH, D_MODEL), 0.02),
        "w_ada": n(ks[9], (DEPTH, D_MODEL, N_MOD * D_MODEL), 0.3 * D_MODEL ** -0.5),
        "b_ada": n(ks[10], (DEPTH, N_MOD * D_MODEL), 0.02),
        "w_in0": n(ks[11], (N_EVEN, D_MODEL, D_PROJ0), D_MODEL ** -0.5),
        "w_pool": n(ks[12], (N_EVEN, N_POOL_GROUPS, POOL_GROUP, POOL_GROUP), POOL_GROUP ** -0.5),
        "s_pool": 1.0 + n(ks[13], (N_EVEN, D_POOL), 0.05),
        "sconv_w": n(ks[14], (N_EVEN, CONV_W, D_SCONV), CONV_W ** -0.5),
        "sconv_b": n(ks[15], (N_EVEN, D_SCONV), 0.02),
        "w_out0": n(ks[16], (N_EVEN, D_MIX0, D_MODEL), D_MIX0 ** -0.5),
        "w_uv1": n(ks[17], (N_ODD, D_MODEL, 2 * D_GATE), D_MODEL ** -0.5),
        "g_v1": 1.0 + n(ks[18], (N_ODD, D_GATE), 0.02),
        "w_s1": n(ks[19], (N_ODD, N_SG_HEADS, CHUNK, CHUNK), CHUNK ** -0.5),
        "b_s1": 1.0 + n(ks[20], (N_ODD, N_SG_HEADS, CHUNK), 0.02),
        "w_out1": n(ks[21], (N_ODD, D_GATE, D_MODEL), D_GATE ** -0.5),
        "ffn_up": n(ks[22], (DEPTH, D_MODEL, 2 * D_FF), D_MODEL ** -0.5),
        "ffn_conv_w": n(ks[23], (DEPTH, CONV_W, 2 * D_FF), CONV_W ** -0.5),
        "ffn_conv_b": n(ks[24], (DEPTH, 2 * D_FF), 0.02),
        "ffn_down": n(ks[25], (DEPTH, D_FF, D_MODEL), D_FF ** -0.5),
        "norm_final": 1.0 + n(ks[26], (D_MODEL,), 0.02),
    }


def reference(x_prompt, x_sample, state_pool, state_sconv, state_ffn, c_prompt, c_sample,
              norm_mix, norm_ffn, w_ada, b_ada, w_in0, w_pool, s_pool, sconv_w, sconv_b,
              w_out0, w_uv1, g_v1, w_s1, b_s1, w_out1, ffn_up, ffn_conv_w, ffn_conv_b,
              ffn_down, norm_final):
    weights = (norm_mix, norm_ffn, w_ada, b_ada, w_in0, w_pool, s_pool, sconv_w, sconv_b,
               w_out0, w_uv1, g_v1, w_s1, b_s1, w_out1, ffn_up, ffn_conv_w, ffn_conv_b,
               ffn_down, norm_final)
    dt = x_prompt.dtype
    pool0 = jnp.zeros((N_EVEN, BATCH, POOL_BUF, D_POOL), dt)
    sconv0 = jnp.zeros((N_EVEN, BATCH, CONV_BUF, D_SCONV), dt)
    ffn0 = jnp.zeros((DEPTH, BATCH, CONV_BUF, 2 * D_FF), dt)
    y_prompt, pool_prompt, sconv_prompt, ffn_prompt, _ = trunk(
        x_prompt, c_prompt, 0, pool0, sconv0, ffn0, *weights)
    y_sample, pool_sample, sconv_sample, ffn_sample, sg_v_sample = trunk(
        x_sample, c_sample, PAST_LEN, state_pool, state_sconv, state_ffn, *weights)
    return (y_prompt, y_sample, pool_prompt, pool_sample, sconv_prompt, sconv_sample,
            ffn_prompt, ffn_sample, sg_v_sample)
```

```cpp
#include <hip/hip_runtime.h>
#include <hip/hip_cooperative_groups.h>
#include <cstdio>
namespace cg = cooperative_groups;

#define LAS __attribute__((address_space(3)))
typedef unsigned short bf16_t;
typedef short bf16x8 __attribute__((ext_vector_type(8)));
typedef float f32x4 __attribute__((ext_vector_type(4)));
typedef float f32x2 __attribute__((ext_vector_type(2)));
typedef unsigned u32x4 __attribute__((ext_vector_type(4)));
typedef unsigned u32x2 __attribute__((ext_vector_type(2)));

constexpr int D = 1024, TP = 16384, TS = 1024, T = TP + TS, SEQ = 2048, NBP = 8, NBS = 128, DSEQ = 8;
constexpr int DFF = 2816, DFF2 = 5632, NMOD = 6144, NMOD2 = 12288, NCROW = 136;
constexpr float EPS = 1e-6f;
constexpr size_t O_Y = 0;
constexpr size_t O_POOLP = (size_t)T * D;
constexpr size_t O_POOLS = O_POOLP + (size_t)NBP * 15 * 512;
constexpr size_t O_SCP = O_POOLS + (size_t)NBS * 15 * 512;
constexpr size_t O_SCS = O_SCP + (size_t)NBP * 2 * 512;
constexpr size_t O_FFNP = O_SCS + (size_t)NBS * 2 * 512;
constexpr size_t O_FFNS = O_FFNP + (size_t)2 * NBP * 2 * DFF2;
constexpr size_t O_SGV = O_FFNS + (size_t)2 * NBS * 2 * DFF2;
constexpr size_t O_END = O_SGV + (size_t)NBS * DSEQ * D;
constexpr size_t WS_WIN0 = 4096;
constexpr size_t WS_WOUT0 = WS_WIN0 + (size_t)2048 * 1024 * 2;
constexpr size_t WS_WUV1 = WS_WOUT0 + (size_t)1024 * 1024 * 2;
constexpr size_t WS_WOUT1 = WS_WUV1 + (size_t)2048 * 1024 * 2;
constexpr size_t WS_WUP = WS_WOUT1 + (size_t)1024 * 1024 * 2;
constexpr size_t WS_WDN = WS_WUP + (size_t)2 * DFF2 * 1024 * 2;
constexpr size_t WS_WADA = WS_WDN + (size_t)2 * 1024 * DFF * 2;
constexpr size_t WS_SC = WS_WADA + (size_t)NMOD2 * 1024 * 2;
constexpr size_t WS_MOD = WS_SC + (size_t)256 * 1024 * 2;
constexpr size_t WS_H = WS_MOD + (size_t)NCROW * NMOD2 * 4;
constexpr size_t WS_CAT = WS_H + (size_t)T * D * 2;
constexpr size_t WS_ACT = WS_CAT + (size_t)T * D * 2;
constexpr size_t WS_RAWF = WS_ACT + (size_t)T * DFF * 2;
constexpr size_t WS_RAWL = WS_RAWF + (size_t)64 * 2 * DFF2 * 4;
constexpr size_t WS_PART = WS_RAWL + (size_t)64 * 2 * DFF2 * 4;
constexpr size_t WS_RAWS = WS_PART + (size_t)T * 16 * 4;
constexpr size_t WS_END = WS_RAWS + (size_t)NBS * 2 * DFF2 * 4;

constexpr int BM = 256, BK = 64, HALF = 128, HTB = HALF * BK * 2, STAGE_BYTES = 8 * HTB, NXCD = 8, WGM = 8;
constexpr int LDS_HALO = STAGE_BYTES;
constexpr int LDS_BYTES = STAGE_BYTES + 8192 + 1024;

struct Params {
    const float* in[27];
    float* out;
    unsigned char* ws;
    int ph_lo, ph_hi;
};

__device__ __forceinline__ unsigned pk2(float lo, float hi) { unsigned r; asm volatile("v_cvt_pk_bf16_f32 %0, %1, %2" : "=v"(r) : "v"(lo), "v"(hi)); return r; }
__device__ __forceinline__ float bf_lo(unsigned w) { return __uint_as_float(w << 16); }
__device__ __forceinline__ float bf_hi(unsigned w) { return __uint_as_float(w & 0xffff0000u); }
__device__ __forceinline__ float gelu_t(float x) {
    const float u = x * (0.7978845608f + 0.0356774081f * x * x);
    const float e = __builtin_amdgcn_exp2f(-2.8853900818f * u);
    return x * __builtin_amdgcn_rcpf(1.0f + e);
}
__device__ __forceinline__ float silu_f(float x) { return x * __builtin_amdgcn_rcpf(1.0f + __builtin_amdgcn_exp2f(-1.4426950409f * x)); }
__device__ __forceinline__ float wave_sum(float v) {
#pragma unroll
    for (int o = 1; o < 64; o <<= 1) v += __shfl_xor(v, o);
    return v;
}
__device__ __forceinline__ float ror1(float x) { return __int_as_float(__builtin_amdgcn_update_dpp(0, __float_as_int(x), 0x121, 0xf, 0xf, false)); }
__device__ __forceinline__ float ror2(float x) { return __int_as_float(__builtin_amdgcn_update_dpp(0, __float_as_int(x), 0x122, 0xf, 0xf, false)); }
#define LDS_WAIT() asm volatile("s_waitcnt lgkmcnt(0)" ::: "memory")

__host__ __device__ __forceinline__ int lds_byte(int r, int c) { const int st = (r >> 4) * 2 + (c >> 5), rr = r & 15, cc = c & 31, ob = rr * 64 + cc * 2; return st * 1024 + (ob ^ (((ob >> 9) & 1) << 5)); }
__host__ __device__ __forceinline__ void stage_rc(int b, int& R, int& C) { const int st = b / 1024, sb = b % 1024, swz = sb ^ (((sb >> 9) & 1) << 5); R = (st >> 1) * 16 + swz / 64; C = (st & 1) * 32 + (swz % 64) / 2; }
__host__ __device__ __forceinline__ int perm32(int rho) { const int n = rho >> 4, i = rho & 15; return 8 * (i >> 2) + 4 * n + (i & 3); }

struct Unit { int pm, pn; };
struct Gemm { const bf16_t* A; const bf16_t* Bt; int M, N, K; };
struct StaticOrder {
    int nM, nN, nwg, G, c;
    __device__ void init(int M, int N, int G_, int c_) { nM = M / BM; nN = N / BM; nwg = nM * nN; G = G_; c = c_; }
    __device__ bool next(int i, Unit& u) const {
        const long L = (long)i * G + c; if (L >= nwg) return false;
        int wgid = (int)L; { const int q = nwg / NXCD, r = nwg % NXCD, xcd = wgid % NXCD, off = wgid / NXCD; wgid = (xcd < r ? xcd * (q + 1) : r * (q + 1) + (xcd - r) * q) + off; }
        const int nig = WGM * nN, gid = wgid / nig, fm = gid * WGM, gsz = (nM - fm) < WGM ? (nM - fm) : WGM;
        u.pm = fm + ((wgid % nig) % gsz); u.pn = (wgid % nig) / gsz; return true;
    }
};

typedef f32x4 Acc[2][2][4][2];

template <class Epi>
__device__ __forceinline__ void gemm_phase(LAS unsigned char* lds, const Gemm g, const Epi& E) {
    const int tid = threadIdx.x, wid = __builtin_amdgcn_readfirstlane(tid >> 6), lane = tid & 63, wr = wid >> 2, wc = wid & 3, fr = lane & 15, fq = lane >> 4;
    const int K = g.K, nt = K / BK;
    StaticOrder S; S.init(g.M, g.N, (int)gridDim.x, (int)blockIdx.x);
    unsigned voffA[2], voffB[2];
#pragma unroll
    for (int i = 0; i < 2; ++i) { int R, C; stage_rc(tid * 16 + i * 8192, R, C); const int Rb = Epi::PERM ? ((R & ~31) + perm32(R & 31)) : R;
        voffA[i] = (unsigned)(R * K + C) * 2u; voffB[i] = (unsigned)(Rb * K + C) * 2u; }
    const size_t kstep = (size_t)(BK * 2);
    const size_t hstep = (size_t)HALF * K * 2;
    const size_t tstep = 2 * hstep;
    const unsigned ldsw = (unsigned)wid * 1024u;
    const int aoff = lds_byte(wr * 64 + fr, fq * 8), boff = lds_byte(wc * 32 + fr, fq * 8);
#define PG8_SA(b, h) (((b) * 2 + (h)) * HTB)
#define PG8_SB(b, h) ((4 + (b) * 2 + (h)) * HTB)
#define PG8_STAGE(bufoff, gbase, voff) do { _Pragma("unroll") for (int _i = 0; _i < 2; ++_i) \
        __builtin_amdgcn_global_load_lds((const unsigned*)((const char*)(gbase) + (voff)[_i]), (LAS unsigned*)(lds + (bufoff) + ldsw + _i * 8192), 16, 0, 0); } while (0)
#define PG8_LDA(dst, b, h) do { _Pragma("unroll") for (int m = 0; m < 4; ++m) _Pragma("unroll") for (int k = 0; k < 2; ++k) dst[m][k] = *(const LAS bf16x8*)(lds + PG8_SA(b, h) + aoff + m * 2048 + k * 1024); } while (0)
#define PG8_LDB(dst, b, h) do { _Pragma("unroll") for (int n = 0; n < 2; ++n) _Pragma("unroll") for (int k = 0; k < 2; ++k) dst[n][k] = *(const LAS bf16x8*)(lds + PG8_SB(b, h) + boff + n * 2048 + k * 1024); } while (0)
#define PG8_MMA(ai, bj, At, Bt) do { __builtin_amdgcn_s_setprio(1); _Pragma("unroll") for (int m = 0; m < 4; ++m) _Pragma("unroll") for (int n = 0; n < 2; ++n) _Pragma("unroll") for (int k = 0; k < 2; ++k) \
        acc[ai][bj][m][n] = __builtin_amdgcn_mfma_f32_16x16x32_bf16(Bt[n][k], At[m][k], acc[ai][bj][m][n], 0, 0, 0); __builtin_amdgcn_s_setprio(0); } while (0)
#define PG8_WAIT_V(n) asm volatile("s_waitcnt vmcnt(" #n ")" ::: "memory")
#define PG8_WAIT_L(n) asm volatile("s_waitcnt lgkmcnt(" #n ")" ::: "memory")
#define PG8_BAR __builtin_amdgcn_s_barrier()
#define PG8_SCHED __builtin_amdgcn_sched_barrier(0)
    Unit cur, nxt; int ui = 0;
    if (!S.next(0, cur)) return;
    Acc acc;
#pragma unroll
    for (int a = 0; a < 2; ++a)
#pragma unroll
        for (int b = 0; b < 2; ++b)
#pragma unroll
            for (int m = 0; m < 4; ++m)
#pragma unroll
                for (int n = 0; n < 2; ++n) acc[a][b][m][n] = (f32x4){0.f, 0.f, 0.f, 0.f};
    bf16x8 At[4][2], B0[2][2], B1[2][2];
    const char* cA = (const char*)g.A + (size_t)cur.pm * tstep; const char* cB = (const char*)g.Bt + (size_t)cur.pn * tstep;
    PG8_STAGE(PG8_SB(0, 0), cB, voffB); PG8_STAGE(PG8_SA(0, 0), cA, voffA); PG8_STAGE(PG8_SB(0, 1), cB + hstep, voffB); PG8_STAGE(PG8_SA(0, 1), cA + hstep, voffA);
    if (wr == 1) PG8_BAR;
    PG8_WAIT_V(4); PG8_BAR;
    PG8_STAGE(PG8_SB(1, 0), cB + kstep, voffB); PG8_STAGE(PG8_SA(1, 0), cA + kstep, voffA); PG8_STAGE(PG8_SB(1, 1), cB + hstep + kstep, voffB);
    PG8_WAIT_V(6); PG8_BAR;
    for (;;) {
        const bool has_next = S.next(ui + 1, nxt);
        const char* nA = has_next ? (const char*)g.A + (size_t)nxt.pm * tstep : cA; const char* nB = has_next ? (const char*)g.Bt + (size_t)nxt.pn * tstep : cB;
        for (int t = 0; t < nt; t += 2) {
            const bool last = (t == nt - 2);
            const char* a1 = cA + (size_t)(t + 1) * kstep;
            const char* a2 = last ? nA : cA + (size_t)(t + 2) * kstep; const char* b2 = last ? nB : cB + (size_t)(t + 2) * kstep;
            const char* a3 = a2 + kstep; const char* b3 = b2 + kstep;
            PG8_LDB(B0, 0, 0); PG8_SCHED; PG8_LDA(At, 0, 0); PG8_STAGE(PG8_SA(1, 1), a1 + hstep, voffA);
            PG8_WAIT_L(8); PG8_BAR; PG8_WAIT_L(0); PG8_MMA(0, 0, At, B0); PG8_BAR; PG8_SCHED;
            PG8_LDB(B1, 0, 1); PG8_STAGE(PG8_SB(0, 0), b2, voffB);
            PG8_BAR; PG8_WAIT_L(0); PG8_MMA(0, 1, At, B1); PG8_BAR;
            PG8_LDA(At, 0, 1); PG8_STAGE(PG8_SA(0, 0), a2, voffA);
            PG8_BAR; PG8_WAIT_L(0); PG8_MMA(1, 0, At, B0); PG8_BAR; PG8_SCHED;
            PG8_STAGE(PG8_SB(0, 1), b2 + hstep, voffB);
            PG8_WAIT_V(6); PG8_BAR; PG8_MMA(1, 1, At, B1); PG8_BAR;
            PG8_LDB(B0, 1, 0); PG8_SCHED; PG8_LDA(At, 1, 0); PG8_STAGE(PG8_SA(0, 1), a2 + hstep, voffA);
            PG8_WAIT_L(8); PG8_BAR; PG8_WAIT_L(0); PG8_MMA(0, 0, At, B0); PG8_BAR; PG8_SCHED;
            PG8_LDB(B1, 1, 1); PG8_STAGE(PG8_SB(1, 0), b3, voffB);
            PG8_BAR; PG8_WAIT_L(0); PG8_MMA(0, 1, At, B1); PG8_BAR;
            PG8_LDA(At, 1, 1); PG8_STAGE(PG8_SA(1, 0), a3, voffA);
            PG8_BAR; PG8_WAIT_L(0); PG8_MMA(1, 0, At, B0); PG8_BAR; PG8_SCHED;
            PG8_STAGE(PG8_SB(1, 1), b3 + hstep, voffB);
            PG8_WAIT_V(6); PG8_BAR; PG8_MMA(1, 1, At, B1); PG8_BAR;
        }
        E(acc, cur, wr, wc, fr, fq, lds);
        if (!has_next) break;
#pragma unroll
        for (int a = 0; a < 2; ++a)
#pragma unroll
            for (int b = 0; b < 2; ++b)
#pragma unroll
                for (int m = 0; m < 4; ++m)
#pragma unroll
                    for (int n = 0; n < 2; ++n) acc[a][b][m][n] = (f32x4){0.f, 0.f, 0.f, 0.f};
        cur = nxt; cA = nA; cB = nB; ++ui;
    }
    PG8_WAIT_V(0);
    if (wr == 0) PG8_BAR;
    PG8_BAR;
#undef PG8_SA
#undef PG8_SB
#undef PG8_STAGE
#undef PG8_LDA
#undef PG8_LDB
#undef PG8_MMA
#undef PG8_WAIT_V
#undef PG8_WAIT_L
#undef PG8_SCHED
}

struct EpiMod {
    static constexpr bool PERM = false;
    float* mod; const float* bias;
    __device__ __forceinline__ void operator()(Acc& acc, const Unit& u, int wr, int wc, int fr, int fq, LAS unsigned char*) const {
        const int col0 = u.pn * BM + wc * 32 + 4 * fq;
#pragma unroll
        for (int ai = 0; ai < 2; ++ai)
#pragma unroll
            for (int m = 0; m < 4; ++m) {
                const int r = ai * HALF + wr * 64 + m * 16 + fr;
                if (r < NCROW) {
#pragma unroll
                    for (int bj = 0; bj < 2; ++bj)
#pragma unroll
                        for (int n = 0; n < 2; ++n) { const int c = col0 + bj * HALF + n * 16;
                            *(f32x4*)(mod + (size_t)r * NMOD2 + c) = acc[ai][bj][m][n] + *(const f32x4*)(bias + c); }
                }
            }
    }
};
struct EpiBf16 {
    static constexpr bool PERM = true;
    bf16_t* O; int ldc;
    __device__ __forceinline__ void operator()(Acc& acc, const Unit& u, int wr, int wc, int fr, int fq, LAS unsigned char*) const {
        const int row0 = u.pm * BM + wr * 64 + fr, col0 = u.pn * BM + wc * 32 + 8 * fq;
#pragma unroll
        for (int ai = 0; ai < 2; ++ai)
#pragma unroll
            for (int m = 0; m < 4; ++m) { bf16_t* rowp = O + (size_t)(row0 + ai * HALF + m * 16) * ldc + col0;
#pragma unroll
                for (int bj = 0; bj < 2; ++bj) { const f32x4 v0 = acc[ai][bj][m][0], v1 = acc[ai][bj][m][1];
                    u32x4 w; w.x = pk2(v0[0], v0[1]); w.y = pk2(v0[2], v0[3]); w.z = pk2(v1[0], v1[1]); w.w = pk2(v1[2], v1[3]);
                    *(u32x4*)(rowp + bj * HALF) = w; } }
    }
};
struct EpiUV {
    static constexpr bool PERM = true;
    bf16_t* U; bf16_t* V; float* part;
    __device__ __forceinline__ void operator()(Acc& acc, const Unit& u, int wr, int wc, int fr, int fq, LAS unsigned char*) const {
        const bool isv = u.pn >= 4; const int pn = isv ? u.pn - 4 : u.pn;
        bf16_t* O = isv ? V : U;
        const int row0 = u.pm * BM + wr * 64 + fr, col0 = pn * BM + wc * 32 + 8 * fq;
#pragma unroll
        for (int ai = 0; ai < 2; ++ai)
#pragma unroll
            for (int m = 0; m < 4; ++m) { const int row = row0 + ai * HALF + m * 16; bf16_t* rowp = O + (size_t)row * D + col0; float ss = 0.f;
#pragma unroll
                for (int bj = 0; bj < 2; ++bj) { f32x4 v0 = acc[ai][bj][m][0], v1 = acc[ai][bj][m][1];
#pragma unroll
                    for (int j = 0; j < 4; ++j) { v0[j] = gelu_t(v0[j]); v1[j] = gelu_t(v1[j]); ss += v0[j] * v0[j] + v1[j] * v1[j]; }
                    u32x4 w; w.x = pk2(v0[0], v0[1]); w.y = pk2(v0[2], v0[3]); w.z = pk2(v1[0], v1[1]); w.w = pk2(v1[2], v1[3]);
                    *(u32x4*)(rowp + bj * HALF) = w; }
                if (isv) { ss += __shfl_xor(ss, 16); ss += __shfl_xor(ss, 32); if (fq == 0) part[(size_t)row * 16 + pn * 4 + wc] = ss; }
            }
    }
};
struct EpiResid {
    static constexpr bool PERM = false;
    const float* xp; const float* xs; float* out; const float* mod; int goff;
    __device__ __forceinline__ void operator()(Acc& acc, const Unit& u, int wr, int wc, int fr, int fq, LAS unsigned char*) const {
        const bool prompt = u.pm < 64;
        const int R0 = u.pm * BM;
        const float* xb = prompt ? xp + (size_t)R0 * D : xs + (size_t)(R0 - TP) * D;
        const int col0 = u.pn * BM + wc * 32 + 4 * fq;
#pragma unroll
        for (int ai = 0; ai < 2; ++ai)
#pragma unroll
            for (int m = 0; m < 4; ++m) { const int r = ai * HALF + wr * 64 + m * 16 + fr;
                const int mrow = prompt ? (u.pm >> 3) : 8 + ((R0 - TP + r) >> 3);
                const float* gp = mod + (size_t)mrow * NMOD2 + goff + col0;
                const float* xr = xb + (size_t)r * D + col0; float* orow = out + (size_t)(R0 + r) * D + col0;
#pragma unroll
                for (int bj = 0; bj < 2; ++bj)
#pragma unroll
                    for (int n = 0; n < 2; ++n) { const int c = bj * HALF + n * 16;
                        *(f32x4*)(orow + c) = *(const f32x4*)(xr + c) + *(const f32x4*)(gp + c) * acc[ai][bj][m][n]; }
                asm volatile("" ::: "memory"); }
    }
};
struct EpiUp {
    static constexpr bool PERM = true;
    bf16_t* act; const float* cw; const float* cb; float* raws; float* rawf; float* rawl; float* ffn_p; float* ffn_s;
    __device__ __forceinline__ void conv_inplace(Acc& acc, const Unit& u, int wr, int fr, int cl, int oc0, int R0, LAS float* hal) const {
#pragma unroll
        for (int bj = 0; bj < 2; ++bj) {
#pragma unroll
            for (int n = 0; n < 2; ++n) {
                const int oc = bj * DFF + oc0 + 4 * n;
                const f32x4 w0 = *(const f32x4*)(cw + oc), w1 = *(const f32x4*)(cw + DFF2 + oc), w2 = *(const f32x4*)(cw + 2 * DFF2 + oc), bb = *(const f32x4*)(cb + oc);
#pragma unroll
                for (int ai = 0; ai < 2; ++ai) {
                    const int blk = ai * 2 + wr;
                    const int hb = blk > 0 ? blk - 1 : 0;
                    f32x4 hp = *(const LAS f32x4*)(hal + (hb * 2 + (fr & 1)) * 256 + bj * HALF + cl + 4 * n);
                    if (blk == 0) hp = (f32x4){0.f, 0.f, 0.f, 0.f};
#pragma unroll
                    for (int mm = 0; mm < 4; ++mm) { const int m = 3 - mm;
                        __builtin_amdgcn_sched_barrier(0);
                        const f32x4 cur = acc[ai][bj][m][n];
                        f32x4 prv;
                        if (m > 0) prv = acc[ai][bj][m - 1][n]; else prv = hp;
                        f32x4 p1, p2;
#pragma unroll
                        for (int j = 0; j < 4; ++j) {
                            const float c1 = ror1(cur[j]), q1 = ror1(prv[j]), c2 = ror2(cur[j]), q2 = ror2(prv[j]);
                            p1[j] = fr >= 1 ? c1 : q1; p2[j] = fr >= 2 ? c2 : q2;
                        }
                        acc[ai][bj][m][n] = bb + w0 * p2 + w1 * p1 + w2 * cur;
                    }
                }
            }
        }
        __builtin_amdgcn_sched_barrier(0);
    }
    __device__ __forceinline__ void operator()(Acc& acc, const Unit& u, int wr, int wc, int fr, int fq, LAS unsigned char* lds) const {
        const bool prompt = u.pm < 64;
        const int R0 = u.pm * BM, cl = wc * 32 + 8 * fq, oc0 = u.pn * HALF + cl;
        LAS float* hal = (LAS float*)(lds + LDS_HALO);
        if (fr >= 14) {
#pragma unroll
            for (int ai = 0; ai < 2; ++ai)
#pragma unroll
                for (int bj = 0; bj < 2; ++bj)
#pragma unroll
                    for (int n = 0; n < 2; ++n) *(LAS f32x4*)(hal + ((ai * 2 + wr) * 2 + (fr - 14)) * 256 + bj * HALF + cl + 4 * n) = acc[ai][bj][3][n];
        }
        if (prompt) {
            if (wr == 1 && fr >= 14) {
#pragma unroll
                for (int bj = 0; bj < 2; ++bj)
#pragma unroll
                    for (int n = 0; n < 2; ++n) { const int oc = bj * DFF + oc0 + 4 * n;
                        *(f32x4*)(rawl + (size_t)(u.pm * 2 + fr - 14) * DFF2 + oc) = acc[1][bj][3][n];
                        if ((u.pm & 7) == 7) *(f32x4*)(ffn_p + (size_t)((u.pm >> 3) * 2 + fr - 14) * DFF2 + oc) = acc[1][bj][3][n]; }
            }
            if (wr == 0 && fr < 2) {
#pragma unroll
                for (int bj = 0; bj < 2; ++bj)
#pragma unroll
                    for (int n = 0; n < 2; ++n) *(f32x4*)(rawf + (size_t)(u.pm * 2 + fr) * DFF2 + bj * DFF + oc0 + 4 * n) = acc[0][bj][0][n];
            }
        } else {
            if ((fr & 7) >= 6 || (fr & 7) < 2) {
                float* dstb = (fr & 7) >= 6 ? ffn_s - (size_t)6 * DFF2 : raws;
#pragma unroll
                for (int ai = 0; ai < 2; ++ai)
#pragma unroll
                    for (int m = 0; m < 4; ++m) { const int b = (R0 - TP + ai * HALF + wr * 64 + m * 16 + fr) >> 3;
#pragma unroll
                        for (int bj = 0; bj < 2; ++bj)
#pragma unroll
                            for (int n = 0; n < 2; ++n) *(f32x4*)(dstb + (size_t)(b * 2 + (fr & 7)) * DFF2 + bj * DFF + oc0 + 4 * n) = acc[ai][bj][m][n]; }
            }
        }
        LDS_WAIT(); PG8_BAR; asm volatile("" ::: "memory"); PG8_BAR; asm volatile("" ::: "memory");
        conv_inplace(acc, u, wr, fr, cl, oc0, R0, hal);
#pragma unroll
        for (int ai = 0; ai < 2; ++ai)
#pragma unroll
            for (int m = 0; m < 4; ++m) { const int r = ai * HALF + wr * 64 + m * 16 + fr;
                f32x4 o0, o1;
#pragma unroll
                for (int j = 0; j < 4; ++j) { o0[j] = gelu_t(acc[ai][0][m][0][j]) * acc[ai][1][m][0][j]; o1[j] = gelu_t(acc[ai][0][m][1][j]) * acc[ai][1][m][1][j]; }
                u32x4 w; w.x = pk2(o0[0], o0[1]); w.y = pk2(o0[2], o0[3]); w.z = pk2(o1[0], o1[1]); w.w = pk2(o1[2], o1[3]);
                *(u32x4*)(act + (size_t)(R0 + r) * DFF + oc0) = w; asm volatile("" ::: "memory"); }
    }
};

__device__ __forceinline__ void transpose_item(const float* W, int ldn, int k0, int n0, bf16_t* WT, size_t dst_row, int dst_pitch, int dst_k, LAS float* scr, int lane) {
#pragma unroll 8
    for (int i = 0; i < 32; ++i) { const int kk = 2 * i + (lane >> 5); scr[kk * 33 + (lane & 31)] = W[(size_t)(k0 + kk) * ldn + n0 + (lane & 31)]; }
    LDS_WAIT(); asm volatile("" ::: "memory");
    const int c = lane & 7;
#pragma unroll
    for (int j = 0; j < 4; ++j) { const int n = (lane >> 3) + 8 * j; const LAS float* s = scr + (8 * c) * 33 + n;
        u32x4 o; o.x = pk2(s[0 * 33], s[1 * 33]); o.y = pk2(s[2 * 33], s[3 * 33]); o.z = pk2(s[4 * 33], s[5 * 33]); o.w = pk2(s[6 * 33], s[7 * 33]);
        *(u32x4*)(WT + (dst_row + n) * dst_pitch + dst_k + k0 + 8 * c) = o; }
    LDS_WAIT(); asm volatile("" ::: "memory");
}
__device__ __forceinline__ void prep_phase(const Params& p, LAS unsigned char* lds) {
    const int tid = threadIdx.x, wave = tid >> 6, lane = tid & 63;
    LAS float* scr = (LAS float*)(lds + wave * 8704);
    const int gw = blockIdx.x * 8 + wave, NGW = gridDim.x * 8;
    unsigned char* ws = p.ws;
    constexpr int I_IN0 = 16 * 64, I_UV = 16 * 64, I_O1 = 16 * 32, I_O0 = 8 * 32, I_UP = 16 * 176, I_DN = 44 * 32, I_ADA = 16 * 192;
    constexpr int NITEMS = I_IN0 + I_UV + I_O1 + I_O0 + 2 * I_UP + 2 * I_DN + 2 * I_ADA;
    for (int it = gw; it < NITEMS; it += NGW) {
        int r = it;
        if (r < I_IN0) { transpose_item(p.in[11], 2048, 64 * (r / 64), 32 * (r % 64), (bf16_t*)(ws + WS_WIN0), 32 * (r % 64), 1024, 0, scr, lane); continue; } r -= I_IN0;
        if (r < I_UV) { transpose_item(p.in[17], 2048, 64 * (r / 64), 32 * (r % 64), (bf16_t*)(ws + WS_WUV1), 32 * (r % 64), 1024, 0, scr, lane); continue; } r -= I_UV;
        if (r < I_O1) { transpose_item(p.in[21], 1024, 64 * (r / 32), 32 * (r % 32), (bf16_t*)(ws + WS_WOUT1), 32 * (r % 32), 1024, 0, scr, lane); continue; } r -= I_O1;
        if (r < I_O0) { transpose_item(p.in[16] + (size_t)512 * 1024, 1024, 64 * (r / 32), 32 * (r % 32), (bf16_t*)(ws + WS_WOUT0), 32 * (r % 32), 1024, 512, scr, lane); continue; } r -= I_O0;
        if (r < 2 * I_UP) { const int l = r / I_UP; r -= l * I_UP; const int n0 = 32 * (r % 176);
            const int drow = n0 < DFF ? 256 * (n0 / 128) + (n0 % 128) : 256 * ((n0 - DFF) / 128) + 128 + ((n0 - DFF) % 128);
            transpose_item(p.in[22] + (size_t)l * 1024 * DFF2, DFF2, 64 * (r / 176), n0, (bf16_t*)(ws + WS_WUP) + (size_t)l * DFF2 * 1024, drow, 1024, 0, scr, lane); continue; } r -= 2 * I_UP;
        if (r < 2 * I_DN) { const int l = r / I_DN; r -= l * I_DN;
            transpose_item(p.in[25] + (size_t)l * DFF * 1024, 1024, 64 * (r / 32), 32 * (r % 32), (bf16_t*)(ws + WS_WDN) + (size_t)l * 1024 * DFF, 32 * (r % 32), DFF, 0, scr, lane); continue; } r -= 2 * I_DN;
        { const int l = r / I_ADA; r -= l * I_ADA;
            transpose_item(p.in[9] + (size_t)l * 1024 * NMOD, NMOD, 64 * (r / 192), 32 * (r % 192), (bf16_t*)(ws + WS_WADA), (size_t)l * NMOD + 32 * (r % 192), 1024, 0, scr, lane); }
    }
    const int gt = blockIdx.x * 512 + tid, NGT = gridDim.x * 512;
    { bf16_t* SC = (bf16_t*)(ws + WS_SC);
      for (int i = gt; i < 256 * 1024 / 2; i += NGT) { const int row = i >> 9, c2 = (i & 511) * 2; unsigned w = 0u;
          if (row < NCROW) { const float* cp = row < 8 ? p.in[5] + row * D + c2 : p.in[6] + (row - 8) * D + c2; w = pk2(silu_f(cp[0]), silu_f(cp[1])); }
          *(unsigned*)(SC + row * D + c2) = w; } }
    { const float* Wp = p.in[12]; const float* sp = p.in[13]; const float* Wo = p.in[16]; bf16_t* WT = (bf16_t*)(ws + WS_WOUT0);
      for (int i = gt; i < 1024 * 128; i += NGT) { const int n = i & 1023, kq = i >> 10, g = kq >> 5, c0 = (kq & 31) * 4;
          float a0 = 0.f, a1 = 0.f, a2 = 0.f, a3 = 0.f; const float* wp = Wp + (size_t)(g * 128 + c0) * 128;
          for (int d = 0; d < 128; ++d) { const float wo = Wo[(size_t)(g * 128 + d) * 1024 + n] * sp[g * 128 + d];
              a0 += wp[d] * wo; a1 += wp[128 + d] * wo; a2 += wp[256 + d] * wo; a3 += wp[384 + d] * wo; }
          u32x2 o; o.x = pk2(a0, a1); o.y = pk2(a2, a3);
          *(u32x2*)(WT + (size_t)n * 1024 + g * 128 + c0) = o; } }
}

__device__ __forceinline__ void norm_phase(const float* xp, const float* xs, const float* gam, const float* mod, int shoff, int scoff, bf16_t* H) {
    const int tid = threadIdx.x, wave = tid >> 6, lane = tid & 63;
    const int gw = blockIdx.x * 8 + wave, NGW = gridDim.x * 8;
    for (int row = gw; row < T; row += NGW) {
        const float* xr = row < TP ? xp + (size_t)row * D : xs + (size_t)(row - TP) * D;
        const int mrow = row < TP ? (row >> 11) : 8 + ((row - TP) >> 3);
        const float* mr = mod + (size_t)mrow * NMOD2;
        f32x4 v[4]; float ss = 0.f;
#pragma unroll
        for (int j = 0; j < 4; ++j) { v[j] = *(const f32x4*)(xr + 4 * (lane + 64 * j)); ss += (v[j][0] * v[j][0] + v[j][1] * v[j][1]) + (v[j][2] * v[j][2] + v[j][3] * v[j][3]); }
        const float rstd = rsqrtf(wave_sum(ss) * (1.0f / D) + EPS);
#pragma unroll
        for (int j = 0; j < 4; ++j) { const int c = 4 * (lane + 64 * j);
            const f32x4 g4 = *(const f32x4*)(gam + c), sc = *(const f32x4*)(mr + scoff + c), sh = *(const f32x4*)(mr + shoff + c);
            const f32x4 o = (v[j] * rstd * g4) * (sc + 1.0f) + sh;
            u32x2 w; w.x = pk2(o[0], o[1]); w.y = pk2(o[2], o[3]);
            *(u32x2*)(H + (size_t)row * D + c) = w; }
    }
}
__device__ __forceinline__ void final_norm_phase(float* x, const float* gam) {
    const int tid = threadIdx.x, wave = tid >> 6, lane = tid & 63;
    const int gw = blockIdx.x * 8 + wave, NGW = gridDim.x * 8;
    for (int row = gw; row < T; row += NGW) {
        float* xr = x + (size_t)row * D;
        f32x4 v[4]; float ss = 0.f;
#pragma unroll
        for (int j = 0; j < 4; ++j) { v[j] = *(const f32x4*)(xr + 4 * (lane + 64 * j)); ss += (v[j][0] * v[j][0] + v[j][1] * v[j][1]) + (v[j][2] * v[j][2] + v[j][3] * v[j][3]); }
        const float rstd = rsqrtf(wave_sum(ss) * (1.0f / D) + EPS);
#pragma unroll
        for (int j = 0; j < 4; ++j) { const int c = 4 * (lane + 64 * j); *(f32x4*)(xr + c) = v[j] * rstd * *(const f32x4*)(gam + c); }
    }
}

__device__ __forceinline__ void ld8(const bf16_t* p, float (&f)[8]) { const u32x4 w = *(const u32x4*)p; f[0] = bf_lo(w.x); f[1] = bf_hi(w.x); f[2] = bf_lo(w.y); f[3] = bf_hi(w.y); f[4] = bf_lo(w.z); f[5] = bf_hi(w.z); f[6] = bf_lo(w.w); f[7] = bf_hi(w.w); }
__device__ __forceinline__ void ld8f(const float* p, float (&f)[8]) { const f32x4 a = *(const f32x4*)p, b = *(const f32x4*)(p + 4); f[0] = a[0]; f[1] = a[1]; f[2] = a[2]; f[3] = a[3]; f[4] = b[0]; f[5] = b[1]; f[6] = b[2]; f[7] = b[3]; }
__device__ __forceinline__ void st8f(float* p, const float (&f)[8]) { *(f32x4*)p = (f32x4){f[0], f[1], f[2], f[3]}; *(f32x4*)(p + 4) = (f32x4){f[4], f[5], f[6], f[7]}; }
__device__ __forceinline__ void st8b(bf16_t* p, const float (&f)[8]) { u32x4 w; w.x = pk2(f[0], f[1]); w.y = pk2(f[2], f[3]); w.z = pk2(f[4], f[5]); w.w = pk2(f[6], f[7]); *(u32x4*)p = w; }

__device__ __forceinline__ void mixer0_phase(const Params& p) {
    const bf16_t* PROJ = (const bf16_t*)(p.ws + WS_ACT); bf16_t* CAT = (bf16_t*)(p.ws + WS_CAT);
    const float* st_pool = p.in[2]; const float* st_sc = p.in[3]; const float* scw = p.in[14]; const float* scb = p.in[15];
    float* out = p.out;
    const int tid = threadIdx.x, sub = tid >> 7, l = tid & 127;
    for (int it = blockIdx.x; it < T / 4; it += gridDim.x) {
        const int row = it * 4 + sub;
        const bool prompt = row < TP;
        const int b = prompt ? row >> 11 : (row - TP) >> 3, t = prompt ? row & 2047 : (row - TP) & 7;
        const bf16_t* pr = PROJ + (size_t)row * 2048;
        if (l < 64) {
            const int c0 = l * 8, g = l >> 4, w = 2 << g;
            float a[8], s[8]; ld8(pr + c0, a);
#pragma unroll
            for (int e = 0; e < 8; ++e) s[e] = a[e];
            float cnt;
            if (prompt) {
                const int nb = t < w - 1 ? t : w - 1;
                for (int k = 1; k <= nb; ++k) { float q[8]; ld8(pr - (size_t)k * 2048 + c0, q);
#pragma unroll
                    for (int e = 0; e < 8; ++e) s[e] += q[e]; }
                cnt = (float)(nb + 1);
                if (t >= SEQ - 15) st8f(out + O_POOLP + ((size_t)b * 15 + (t - (SEQ - 15))) * 512 + c0, a);
            } else {
                for (int k = 1; k < w; ++k) { float q[8]; const int tt = t - k;
                    if (tt >= 0) ld8(pr - (size_t)k * 2048 + c0, q); else ld8f(st_pool + ((size_t)b * 15 + (15 + tt)) * 512 + c0, q);
#pragma unroll
                    for (int e = 0; e < 8; ++e) s[e] += q[e]; }
                cnt = (float)w;
                st8f(out + O_POOLS + ((size_t)b * 15 + 7 + t) * 512 + c0, a);
                if (t < 7) { float q[8]; ld8f(st_pool + ((size_t)b * 15 + 8 + t) * 512 + c0, q); st8f(out + O_POOLS + ((size_t)b * 15 + t) * 512 + c0, q); }
            }
            const float inv = 1.0f / cnt; float d[8];
#pragma unroll
            for (int e = 0; e < 8; ++e) d[e] = s[e] * inv - a[e];
            st8b(CAT + (size_t)row * D + c0, d);
        } else {
            const int c0 = (l - 64) * 8;
            float xin[8], bg[8], cgv[8], s0[8], s1[8], s2[8];
            ld8(pr + 512 + c0, xin); ld8(pr + 1024 + c0, bg); ld8(pr + 1536 + c0, cgv);
#pragma unroll
            for (int e = 0; e < 8; ++e) s2[e] = cgv[e] * xin[e];
            if (t >= 1) { float x1[8], c1[8]; ld8(pr - 2048 + 512 + c0, x1); ld8(pr - 2048 + 1536 + c0, c1);
#pragma unroll
                for (int e = 0; e < 8; ++e) s1[e] = c1[e] * x1[e]; }
            else if (prompt) {
#pragma unroll
                for (int e = 0; e < 8; ++e) s1[e] = 0.f; }
            else ld8f(st_sc + ((size_t)b * 2 + 1) * 512 + c0, s1);
            if (t >= 2) { float x1[8], c1[8]; ld8(pr - 4096 + 512 + c0, x1); ld8(pr - 4096 + 1536 + c0, c1);
#pragma unroll
                for (int e = 0; e < 8; ++e) s0[e] = c1[e] * x1[e]; }
            else if (prompt) {
#pragma unroll
                for (int e = 0; e < 8; ++e) s0[e] = 0.f; }
            else ld8f(st_sc + ((size_t)b * 2 + t) * 512 + c0, s0);
            float w0[8], w1[8], w2[8], bb[8], y[8];
            ld8f(scw + c0, w0); ld8f(scw + 512 + c0, w1); ld8f(scw + 1024 + c0, w2); ld8f(scb + c0, bb);
#pragma unroll
            for (int e = 0; e < 8; ++e) y[e] = bg[e] * (bb[e] + w0[e] * s0[e] + w1[e] * s1[e] + w2[e] * s2[e]);
            st8b(CAT + (size_t)row * D + 512 + c0, y);
            if (prompt) { if (t >= SEQ - 2) st8f(out + O_SCP + ((size_t)b * 2 + (t - (SEQ - 2))) * 512 + c0, s2); }
            else if (t >= DSEQ - 2) st8f(out + O_SCS + ((size_t)b * 2 + (t - (DSEQ - 2))) * 512 + c0, s2);
        }
    }
}

__device__ __forceinline__ void fixup_phase(const Params& p, int l) {
    const float* rawf = (const float*)(p.ws + WS_RAWF); const float* rawl = (const float*)(p.ws + WS_RAWL);
    const float* cw = p.in[23] + (size_t)l * 3 * DFF2; const float* cb = p.in[24] + (size_t)l * DFF2;
    bf16_t* act = (bf16_t*)(p.ws + WS_ACT);
    const int gt = blockIdx.x * 512 + threadIdx.x, NGT = gridDim.x * 512;
    for (int i = gt; i < 56 * 2 * (DFF / 8); i += NGT) {
        const int c0 = (i % (DFF / 8)) * 8, ri = (i / (DFF / 8)) & 1, tq = i / (2 * (DFF / 8));
        const int pm = (tq / 7) * 8 + 1 + (tq % 7);
        float o[8], gv[2][8];
#pragma unroll
        for (int h = 0; h < 2; ++h) { const int oc = h * DFF + c0;
            float cur[8], p1[8], p2[8], w0[8], w1[8], w2[8], bb[8];
            ld8f(rawf + (size_t)(pm * 2 + ri) * DFF2 + oc, cur);
            if (ri == 0) { ld8f(rawl + (size_t)((pm - 1) * 2 + 1) * DFF2 + oc, p1); ld8f(rawl + (size_t)((pm - 1) * 2) * DFF2 + oc, p2); }
            else { ld8f(rawf + (size_t)(pm * 2) * DFF2 + oc, p1); ld8f(rawl + (size_t)((pm - 1) * 2 + 1) * DFF2 + oc, p2); }
            ld8f(cw + oc, w0); ld8f(cw + DFF2 + oc, w1); ld8f(cw + 2 * DFF2 + oc, w2); ld8f(cb + oc, bb);
#pragma unroll
            for (int e = 0; e < 8; ++e) gv[h][e] = bb[e] + w0[e] * p2[e] + w1[e] * p1[e] + w2[e] * cur[e]; }
#pragma unroll
        for (int e = 0; e < 8; ++e) o[e] = gelu_t(gv[0][e]) * gv[1][e];
        st8b(act + (size_t)(pm * 256 + ri) * DFF + c0, o);
    }
    const float* raws = (const float*)(p.ws + WS_RAWS); const float* state = p.in[4] + (size_t)l * NBS * 2 * DFF2;
    for (int i = gt; i < NBS * 2 * (DFF / 8); i += NGT) {
        const int c0 = (i % (DFF / 8)) * 8, ri = (i / (DFF / 8)) & 1, b = i / (2 * (DFF / 8));
        float o[8], gv[2][8];
#pragma unroll
        for (int h = 0; h < 2; ++h) { const int oc = h * DFF + c0;
            float cur[8], p1[8], p2[8], w0[8], w1[8], w2[8], bb[8];
            ld8f(raws + (size_t)(b * 2 + ri) * DFF2 + oc, cur);
            if (ri == 0) { ld8f(state + (size_t)(b * 2 + 1) * DFF2 + oc, p1); ld8f(state + (size_t)(b * 2) * DFF2 + oc, p2); }
            else { ld8f(raws + (size_t)(b * 2) * DFF2 + oc, p1); ld8f(state + (size_t)(b * 2 + 1) * DFF2 + oc, p2); }
            ld8f(cw + oc, w0); ld8f(cw + DFF2 + oc, w1); ld8f(cw + 2 * DFF2 + oc, w2); ld8f(cb + oc, bb);
#pragma unroll
            for (int e = 0; e < 8; ++e) gv[h][e] = bb[e] + w0[e] * p2[e] + w1[e] * p1[e] + w2[e] * cur[e]; }
#pragma unroll
        for (int e = 0; e < 8; ++e) o[e] = gelu_t(gv[0][e]) * gv[1][e];
        st8b(act + (size_t)(TP + b * 8 + ri) * DFF + c0, o);
    }
}

constexpr int SP_PITCH = 136;
__device__ __forceinline__ void spatial_phase(const Params& p, LAS unsigned char* lds) {
    const bf16_t* U = (const bf16_t*)(p.ws + WS_ACT); const bf16_t* V = U + (size_t)T * D; const float* part = (const float*)(p.ws + WS_PART);
    bf16_t* CAT = (bf16_t*)(p.ws + WS_CAT);
    const float* gv = p.in[18]; const float* Ws = p.in[19]; const float* bs = p.in[20];
    LAS bf16_t* As = (LAS bf16_t*)lds; LAS bf16_t* Vt = (LAS bf16_t*)(lds + 128 * SP_PITCH * 2); LAS float* rs = (LAS float*)(lds + 2 * 128 * SP_PITCH * 2);
    const int tid = threadIdx.x, wave = tid >> 6, lane = tid & 63, fr = lane & 15, fq = lane >> 4;
    for (int it = blockIdx.x; it < 1024 + NBS; it += gridDim.x) {
        __syncthreads();
        if (it < 1024) {
            const int ch = it >> 3, h = it & 7, row0 = ch * 128;
            if (tid < 128) { const float* pp = part + (size_t)(row0 + tid) * 16; float s = 0.f;
#pragma unroll
                for (int j = 0; j < 4; ++j) { const f32x4 q = *(const f32x4*)(pp + 4 * j); s += (q[0] + q[1]) + (q[2] + q[3]); }
                rs[tid] = rsqrtf(s * (1.0f / D) + EPS); }
#pragma unroll
            for (int i = 0; i < 8; ++i) { const int id = tid + 512 * i, t = id >> 5, s4 = (id & 31) * 4;
                const f32x4 w = *(const f32x4*)(Ws + ((size_t)h * 128 + t) * 128 + s4);
                u32x2 o; o.x = pk2(s4 <= t ? w[0] : 0.f, s4 + 1 <= t ? w[1] : 0.f); o.y = pk2(s4 + 2 <= t ? w[2] : 0.f, s4 + 3 <= t ? w[3] : 0.f);
                *(LAS u32x2*)(As + t * SP_PITCH + s4) = o; }
            __syncthreads();
#pragma unroll
            for (int i = 0; i < 4; ++i) { const int id = tid + 512 * i, s = id >> 4, d8 = (id & 15) * 8;
                float f[8], g8[8]; ld8(V + (size_t)(row0 + s) * D + h * 128 + d8, f); ld8f(gv + h * 128 + d8, g8);
                const float r = rs[s];
#pragma unroll
                for (int e = 0; e < 8; ++e) { const unsigned w = pk2(f[e] * r * g8[e], 0.f); Vt[(d8 + e) * SP_PITCH + s] = (bf16_t)(w & 0xffffu); } }
            __syncthreads();
            const int tb = 32 * (wave >> 1), db = 64 * (wave & 1);
            f32x4 acc[2][4];
#pragma unroll
            for (int m = 0; m < 2; ++m)
#pragma unroll
                for (int n = 0; n < 4; ++n) acc[m][n] = (f32x4){0.f, 0.f, 0.f, 0.f};
            for (int kk = 0; kk <= (wave >> 1); ++kk) {
                bf16x8 af[2], bfr[4];
#pragma unroll
                for (int m = 0; m < 2; ++m) af[m] = *(const LAS bf16x8*)(As + (tb + 16 * m + fr) * SP_PITCH + 32 * kk + 8 * fq);
#pragma unroll
                for (int n = 0; n < 4; ++n) bfr[n] = *(const LAS bf16x8*)(Vt + (db + 16 * n + fr) * SP_PITCH + 32 * kk + 8 * fq);
#pragma unroll
                for (int m = 0; m < 2; ++m)
#pragma unroll
                    for (int n = 0; n < 4; ++n) acc[m][n] = __builtin_amdgcn_mfma_f32_16x16x32_bf16(bfr[n], af[m], acc[m][n], 0, 0, 0);
            }
#pragma unroll
            for (int m = 0; m < 2; ++m) { const int t = tb + 16 * m + fr; const float bias = bs[h * 128 + t];
#pragma unroll
                for (int n = 0; n < 4; ++n) { const int d0 = db + 16 * n + 4 * fq; const size_t off = (size_t)(row0 + t) * D + h * 128 + d0;
                    const u32x2 uw = *(const u32x2*)(U + off);
                    u32x2 o; o.x = pk2(bf_lo(uw.x) * (acc[m][n][0] + bias), bf_hi(uw.x) * (acc[m][n][1] + bias)); o.y = pk2(bf_lo(uw.y) * (acc[m][n][2] + bias), bf_hi(uw.y) * (acc[m][n][3] + bias));
                    *(u32x2*)(CAT + off) = o; } }
        } else {
            const int b = it - 1024, row0 = TP + b * 8;
            if (tid < 8) { const float* pp = part + (size_t)(row0 + tid) * 16; float s = 0.f;
#pragma unroll
                for (int j = 0; j < 4; ++j) { const f32x4 q = *(const f32x4*)(pp + 4 * j); s += (q[0] + q[1]) + (q[2] + q[3]); }
                rs[tid] = rsqrtf(s * (1.0f / D) + EPS); }
            __syncthreads();
            const int c = tid * 2, h = tid >> 6;
            const f32x2 g2 = *(const f32x2*)(gv + c);
            float vn0[8], vn1[8];
#pragma unroll
            for (int s = 0; s < 8; ++s) { const unsigned w = *(const unsigned*)(V + (size_t)(row0 + s) * D + c); const float r = rs[s];
                vn0[s] = bf_lo(w) * r * g2[0]; vn1[s] = bf_hi(w) * r * g2[1];
                *(f32x2*)(p.out + O_SGV + ((size_t)b * 8 + s) * D + c) = (f32x2){vn0[s], vn1[s]}; }
#pragma unroll 1
            for (int t = 0; t < 8; ++t) { float z0 = bs[h * 128 + t], z1 = z0; const float* wrow = Ws + ((size_t)h * 128 + t) * 128;
#pragma unroll
                for (int s = 0; s < 8; ++s) { const float w = s <= t ? wrow[s] : 0.f; z0 += w * vn0[s]; z1 += w * vn1[s]; }
                const unsigned uw = *(const unsigned*)(U + (size_t)(row0 + t) * D + c);
                *(unsigned*)(CAT + (size_t)(row0 + t) * D + c) = pk2(bf_lo(uw) * z0, bf_hi(uw) * z1); }
        }
    }
    __syncthreads();
}

constexpr int N_PHASES = 19;
#define CAS __attribute__((address_space(4)))
__device__ __forceinline__ Params load_params() {
#if defined(__HIP_DEVICE_COMPILE__)
    const CAS Params* q = (const CAS Params*)__builtin_amdgcn_kernarg_segment_ptr();
    asm volatile("" : "+s"(q));
    return *q;
#else
    return Params{};
#endif
}
template <bool COOP>
__global__ void __launch_bounds__(512, 2) fwd_kernel(Params p) {
    extern __shared__ __attribute__((aligned(16))) unsigned char shm[];
    LAS unsigned char* lds = (LAS unsigned char*)shm;
    const int ph_lo = p.ph_lo, ph_hi = p.ph_hi;
#ifdef ONLY
#define PHASE(i) if ((i) == ONLY && ph_lo <= (i) && (i) < ph_hi)
#else
#define PHASE(i) if (ph_lo <= (i) && (i) < ph_hi)
#endif
#define SYNC(i) do { if (COOP) { if (ph_lo <= (i) && (i) + 1 < ph_hi) cg::this_grid().sync(); } } while (0)
#define LP const Params q = load_params(); unsigned char* ws = q.ws; float* out = q.out; (void)out; (void)ws
#define MOD ((float*)(ws + WS_MOD))
#define HB ((bf16_t*)(ws + WS_H))
#define CATB ((bf16_t*)(ws + WS_CAT))
#define ACTB ((bf16_t*)(ws + WS_ACT))
#define XOP ((const float*)out)
#define XOS ((const float*)out + (size_t)TP * D)
    PHASE(0) { LP; prep_phase(q, lds); } SYNC(0);
    PHASE(1) { LP; Gemm g{(const bf16_t*)(ws + WS_SC), (const bf16_t*)(ws + WS_WADA), 256, NMOD2, 1024}; EpiMod e{MOD, q.in[10]}; gemm_phase(lds, g, e); } SYNC(1);
    PHASE(2) { LP; norm_phase(q.in[0], q.in[1], q.in[7], MOD, 0, 1024, HB); } SYNC(2);
    PHASE(3) { LP; Gemm g{HB, (const bf16_t*)(ws + WS_WIN0), T, 2048, 1024}; EpiBf16 e{ACTB, 2048}; gemm_phase(lds, g, e); } SYNC(3);
    PHASE(4) { LP; mixer0_phase(q); } SYNC(4);
    PHASE(5) { LP; Gemm g{CATB, (const bf16_t*)(ws + WS_WOUT0), T, 1024, 1024}; EpiResid e{q.in[0], q.in[1], out, MOD, 2048}; gemm_phase(lds, g, e); } SYNC(5);
    PHASE(6) { LP; norm_phase(XOP, XOS, q.in[8], MOD, 3072, 4096, HB); } SYNC(6);
    PHASE(7) { LP; Gemm g{HB, (const bf16_t*)(ws + WS_WUP), T, DFF2, 1024};
        EpiUp e{ACTB, q.in[23], q.in[24], (float*)(ws + WS_RAWS), (float*)(ws + WS_RAWF), (float*)(ws + WS_RAWL), out + O_FFNP, out + O_FFNS}; gemm_phase(lds, g, e); } SYNC(7);
    PHASE(8) { LP; fixup_phase(q, 0); } SYNC(8);
    PHASE(9) { LP; Gemm g{ACTB, (const bf16_t*)(ws + WS_WDN), T, 1024, DFF}; EpiResid e{XOP, XOS, out, MOD, 5120}; gemm_phase(lds, g, e); } SYNC(9);
    PHASE(10) { LP; norm_phase(XOP, XOS, q.in[7] + D, MOD, NMOD + 0, NMOD + 1024, HB); } SYNC(10);
    PHASE(11) { LP; Gemm g{HB, (const bf16_t*)(ws + WS_WUV1), T, 2048, 1024}; EpiUV e{ACTB, ACTB + (size_t)T * D, (float*)(ws + WS_PART)}; gemm_phase(lds, g, e); } SYNC(11);
    PHASE(12) { LP; spatial_phase(q, lds); } SYNC(12);
    PHASE(13) { LP; Gemm g{CATB, (const bf16_t*)(ws + WS_WOUT1), T, 1024, 1024}; EpiResid e{XOP, XOS, out, MOD, NMOD + 2048}; gemm_phase(lds, g, e); } SYNC(13);
    PHASE(14) { LP; norm_phase(XOP, XOS, q.in[8] + D, MOD, NMOD + 3072, NMOD + 4096, HB); } SYNC(14);
    PHASE(15) { LP; Gemm g{HB, (const bf16_t*)(ws + WS_WUP) + (size_t)DFF2 * 1024, T, DFF2, 1024};
        EpiUp e{ACTB, q.in[23] + (size_t)3 * DFF2, q.in[24] + DFF2, (float*)(ws + WS_RAWS), (float*)(ws + WS_RAWF), (float*)(ws + WS_RAWL),
                out + O_FFNP + (size_t)NBP * 2 * DFF2, out + O_FFNS + (size_t)NBS * 2 * DFF2}; gemm_phase(lds, g, e); } SYNC(15);
    PHASE(16) { LP; fixup_phase(q, 1); } SYNC(16);
    PHASE(17) { LP; Gemm g{ACTB, (const bf16_t*)(ws + WS_WDN) + (size_t)1024 * DFF, T, 1024, DFF}; EpiResid e{XOP, XOS, out, MOD, NMOD + 5120}; gemm_phase(lds, g, e); } SYNC(17);
    PHASE(18) { LP; final_norm_phase(out, q.in[26]); }
#undef PHASE
#undef SYNC
}

#ifndef MULTI_LAUNCH
#define MULTI_LAUNCH 1
#endif
extern "C" void kernel_launch(void* const* d_in, const int* in_sizes, int n_in, void* d_out, int out_size, void* d_ws, size_t ws_size, hipStream_t stream) {
    static int grid = 0;
    if (grid == 0) {
        if (n_in != 27 || (size_t)out_size != O_END || ws_size < WS_END) { fprintf(stderr, "kernel_launch: unexpected shapes (n_in %d, out %d, ws %zu, need %zu)\n", n_in, out_size, ws_size, (size_t)WS_END); grid = -1; return; }
        int dev = 0, cus = 0, per_cu = 0;
        hipGetDevice(&dev); hipDeviceGetAttribute(&cus, hipDeviceAttributeMultiprocessorCount, dev);
        hipFuncSetAttribute((const void*)fwd_kernel<true>, hipFuncAttributeMaxDynamicSharedMemorySize, LDS_BYTES);
        hipFuncSetAttribute((const void*)fwd_kernel<false>, hipFuncAttributeMaxDynamicSharedMemorySize, LDS_BYTES);
        hipOccupancyMaxActiveBlocksPerMultiprocessor(&per_cu, (const void*)fwd_kernel<true>, 512, LDS_BYTES);
        if (per_cu < 1) { fprintf(stderr, "kernel_launch: occupancy query says %d blocks/CU\n", per_cu); per_cu = 1; }
        if (per_cu > 1) per_cu = 1;
        grid = cus * per_cu;
        (void)hipGetLastError();
    }
    if (grid < 0) return;
    Params p{};
    for (int i = 0; i < 27; ++i) p.in[i] = (const float*)d_in[i];
    p.out = (float*)d_out; p.ws = (unsigned char*)d_ws;
#if MULTI_LAUNCH
    for (int ph = 0; ph < N_PHASES; ++ph) { p.ph_lo = ph; p.ph_hi = ph + 1;
        hipLaunchKernelGGL(fwd_kernel<false>, dim3(grid), dim3(512), LDS_BYTES, stream, p); }
#else
    p.ph_lo = 0; p.ph_hi = N_PHASES;
    void* args[] = {&p};
    hipError_t e = hipLaunchCooperativeKernel((const void*)fwd_kernel<true>, dim3(grid), dim3(512), args, LDS_BYTES, stream);
    if (e != hipSuccess) fprintf(stderr, "cooperative launch failed: %s (grid %d)\n", hipGetErrorString(e), grid);
#endif
}
```
